# Optimizing an MI355X kernel written in HIP

```python
import jax, jax.numpy as jnp
from jax import lax
import numpy as np

D_MODEL = 1024
BATCH = 4
SEQ = 4096
DEPTH = 1

CHUNK = 64
Q_BLOCK = 128
HEAD_DIM = 64
N_SB_HEADS = 8
N_FOX_HEADS = 8
SB_WIDTH = N_SB_HEADS * HEAD_DIM
FOX_WIDTH = N_FOX_HEADS * HEAD_DIM
D_FF = -(-(8 * D_MODEL) // (3 * 256)) * 256
N_COND = 6
LN_EPS = 1e-5
DEEPNORM_ALPHA = (2 * DEPTH) ** 0.25
DEEPNORM_BETA = (8 * DEPTH) ** -0.25
OFF_SB = 0
OFF_FOX = OFF_SB + 3 * SB_WIDTH
OFF_FGATE = OFF_FOX + 3 * FOX_WIDTH
OFF_BGATE = OFF_FGATE + N_FOX_HEADS
IN_COLS = OFF_BGATE + 2 * D_MODEL

kernel_name = "hybrid_stickbreak_fox_gated_block"


def layer_norm(x, gain=None, bias=None):
    xf = x.astype(jnp.float32)
    mu = jnp.mean(xf, axis=-1, keepdims=True)
    var = jnp.mean(jnp.square(xf - mu), axis=-1, keepdims=True)
    y = (xf - mu) * lax.rsqrt(var + LN_EPS)
    if gain is not None:
        y = y * gain.astype(jnp.float32) + bias.astype(jnp.float32)
    return y.astype(x.dtype)


def modulate(x, shift, scale):
    return layer_norm(x) * (1.0 + scale[:, None, :]) + shift[:, None, :]


def split_heads(t, n_heads):
    b, s, _ = t.shape
    return t.reshape(b, s, n_heads, HEAD_DIM).transpose(0, 2, 1, 3)


def merge_heads(t):
    b, h, s, d = t.shape
    return t.transpose(0, 2, 1, 3).reshape(b, s, h * d)


def stick_breaking_attention(q, k, v):
    seq = q.shape[2]
    scale = HEAD_DIM ** -0.5
    outs = []
    for i in range(seq // Q_BLOCK):
        q0 = i * Q_BLOCK
        kv_len = q0 + Q_BLOCK
        qb = q[:, :, q0:kv_len]
        kb = k[:, :, :kv_len]
        vb = v[:, :, :kv_len]
        z = jnp.einsum('bhqd,bhkd->bhqk', qb, kb, preferred_element_type=jnp.float32) * scale
        qpos = q0 + jnp.arange(Q_BLOCK)[:, None]
        kpos = jnp.arange(kv_len)[None, :]
        mask = kpos < qpos
        log_1m = jnp.where(mask, jax.nn.log_sigmoid(-z), 0.0)
        suffix = lax.cumsum(log_1m, axis=3, reverse=True) - log_1m
        a = jnp.where(mask, jnp.exp(jax.nn.log_sigmoid(z) + suffix), 0.0)
        outs.append(jnp.einsum('bhqk,bhkd->bhqd', a.astype(v.dtype), vb))
    return jnp.concatenate(outs, axis=2)


def forgetting_attention(q, k, v, f_cum):
    seq = q.shape[2]
    scale = HEAD_DIM ** -0.5
    outs = []
    for i in range(seq // Q_BLOCK):
        q0 = i * Q_BLOCK
        kv_len = q0 + Q_BLOCK
        qb = q[:, :, q0:kv_len]
        kb = k[:, :, :kv_len]
        vb = v[:, :, :kv_len]
        z = (jnp.einsum('bhqd,bhkd->bhqk', qb, kb, preferred_element_type=jnp.float32) * scale
             + f_cum[:, :, q0:kv_len, None] - f_cum[:, :, None, :kv_len])
        qpos = q0 + jnp.arange(Q_BLOCK)[:, None]
        kpos = jnp.arange(kv_len)[None, :]
        p = jax.nn.softmax(jnp.where(kpos <= qpos, z, -jnp.inf), axis=-1)
        outs.append(jnp.einsum('bhqk,bhkd->bhqd', p.astype(v.dtype), vb))
    return jnp.concatenate(outs, axis=2)


def setup_inputs(seed: int = 0) -> dict:
    key = jax.random.key(seed)
    ks = jax.random.split(key, 20)
    f32 = jnp.float32
    nrm = lambda k, shape, s: (jax.random.normal(k, shape, f32) * s).astype(f32)
    return {
        "x": nrm(ks[0], (BATCH, SEQ, D_MODEL), 1.0),
        "c": nrm(ks[1], (BATCH, D_MODEL), 1.0),
        "w_ada": nrm(ks[2], (DEPTH, D_MODEL, N_COND * D_MODEL), 0.5 * D_MODEL ** -0.5),
        "b_ada": nrm(ks[3], (DEPTH, N_COND * D_MODEL), 0.02),
        "w_in": nrm(ks[4], (DEPTH, D_MODEL, IN_COLS), D_MODEL ** -0.5),
        "b_gate": nrm(ks[5], (DEPTH, 2 * D_MODEL), 0.02),
        "b_forget": 3.0 + nrm(ks[6], (DEPTH, N_FOX_HEADS), 1.0),
        "w_sb_out": nrm(ks[7], (DEPTH, SB_WIDTH, D_MODEL), SB_WIDTH ** -0.5),
        "w_fox_out": nrm(ks[8], (DEPTH, FOX_WIDTH, D_MODEL), FOX_WIDTH ** -0.5),
        "w_o": nrm(ks[9], (DEPTH, D_MODEL, D_MODEL), DEEPNORM_BETA * D_MODEL ** -0.5),
        "ln1_g": 1.0 + nrm(ks[10], (DEPTH, D_MODEL), 0.02),
        "ln1_b": nrm(ks[11], (DEPTH, D_MODEL), 0.02),
        "w_ffn_gate": nrm(ks[12], (DEPTH, D_MODEL, D_FF), D_MODEL ** -0.5),
        "w_ffn_up": nrm(ks[13], (DEPTH, D_MODEL, D_FF), D_MODEL ** -0.5),
        "w_ffn_down": nrm(ks[14], (DEPTH, D_FF, D_MODEL), DEEPNORM_BETA * D_FF ** -0.5),
        "ln2_g": 1.0 + nrm(ks[15], (DEPTH, D_MODEL), 0.02),
        "ln2_b": nrm(ks[16], (DEPTH, D_MODEL), 0.02),
    }


def reference(x, c, w_ada, b_ada, w_in, b_gate, b_forget, w_sb_out, w_fox_out, w_o,
              ln1_g, ln1_b, w_ffn_gate, w_ffn_up, w_ffn_down, ln2_g, ln2_b):
    c_act = jax.nn.silu(c)
    for l in range(DEPTH):
        ada = c_act @ w_ada[l] + b_ada[l]
        sh1, sc1, g1, sh2, sc2, g2 = jnp.split(ada, N_COND, axis=-1)

        u = modulate(x, sh1, sc1)
        proj = u @ w_in[l]
        q_sb = split_heads(proj[..., OFF_SB:OFF_SB + SB_WIDTH], N_SB_HEADS)
        k_sb = split_heads(proj[..., OFF_SB + SB_WIDTH:OFF_SB + 2 * SB_WIDTH], N_SB_HEADS)
        v_sb = split_heads(proj[..., OFF_SB + 2 * SB_WIDTH:OFF_FOX], N_SB_HEADS)
        q_fx = split_heads(proj[..., OFF_FOX:OFF_FOX + FOX_WIDTH], N_FOX_HEADS)
        k_fx = split_heads(proj[..., OFF_FOX + FOX_WIDTH:OFF_FOX + 2 * FOX_WIDTH], N_FOX_HEADS)
        v_fx = split_heads(proj[..., OFF_FOX + 2 * FOX_WIDTH:OFF_FGATE], N_FOX_HEADS)
        f_logit = proj[..., OFF_FGATE:OFF_BGATE].astype(jnp.float32) + b_forget[l].astype(jnp.float32)
        f_cum = jnp.cumsum(jax.nn.log_sigmoid(f_logit), axis=1).transpose(0, 2, 1)
        gate_logit = proj[..., OFF_BGATE:] + b_gate[l]
        g_sb = jax.nn.sigmoid(gate_logit[..., :D_MODEL])
        g_fx = jax.nn.sigmoid(gate_logit[..., D_MODEL:])

        y_sb = merge_heads(stick_breaking_attention(q_sb, k_sb, v_sb)) @ w_sb_out[l]
        y_fx = merge_heads(forgetting_attention(q_fx, k_fx, v_fx, f_cum)) @ w_fox_out[l]
        mix = (g_sb * y_sb + g_fx * y_fx) @ w_o[l]
        x = layer_norm(DEEPNORM_ALPHA * x + g1[:, None, :] * mix, ln1_g[l], ln1_b[l])

        u = modulate(x, sh2, sc2)
        h = (jax.nn.silu(u @ w_ffn_gate[l]) * (u @ w_ffn_up[l])) @ w_ffn_down[l]
        x = layer_norm(DEEPNORM_ALPHA * x + g2[:, None, :] * h, ln2_g[l], ln2_b[l])
    return x
```

```cpp
#define MK_LAUNCHES 10
#include <hip/hip_runtime.h>
#include <hip/hip_cooperative_groups.h>
#include <cstdio>
#include <cstdint>
namespace cg = cooperative_groups;
namespace pg8 {
#define PG8_LAS __attribute__((address_space(3)))
typedef unsigned short bf16_t;
typedef short bf16x8 __attribute__((ext_vector_type(8)));
typedef float f32x4 __attribute__((ext_vector_type(4)));
typedef unsigned u32x4 __attribute__((ext_vector_type(4)));
constexpr int BM = 256, BK = 64, HALF = 128, HTB = HALF * BK * 2  , STAGE_BYTES = 8 * HTB, NXCD = 8, WGM = 8;

__host__ __device__ __forceinline__ int lds_byte(int r, int c) { const int st = (r >> 4) * 2 + (c >> 5), rr = r & 15, cc = c & 31, ob = rr * 64 + cc * 2; return st * 1024 + (ob ^ (((ob >> 9) & 1) << 5)); }
__host__ __device__ __forceinline__ void stage_rc(int b, int& R, int& C) { const int st = b / 1024, sb = b % 1024, swz = sb ^ (((sb >> 9) & 1) << 5); R = (st >> 1) * 16 + swz / 64; C = (st & 1) * 32 + (swz % 64) / 2; }
__host__ __device__ __forceinline__ int perm32(int rho) { const int n = rho >> 4, i = rho & 15; return 8 * (i >> 2) + 4 * n + (i & 3); }

struct Unit { int pm, pn; };
struct Gemm { const bf16_t* A; const bf16_t* Bt; int M, N, K; };

struct StaticOrder {
    int nM, nN, nwg, G, c;
    __host__ __device__ void init(int M, int N, int G_, int c_) { nM = M / BM; nN = N / BM; nwg = nM * nN; G = G_; c = c_; }
    __host__ __device__ bool next(int i, Unit& u) const {
        const long L = (long)i * G + c; if (L >= nwg) return false;
        int wgid = (int)L; { const int q = nwg / NXCD, r = nwg % NXCD, xcd = wgid % NXCD, off = wgid / NXCD; wgid = (xcd < r ? xcd * (q + 1) : r * (q + 1) + (xcd - r) * q) + off; }
        const int nig = WGM * nN, gid = wgid / nig, fm = gid * WGM, gsz = (nM - fm) < WGM ? (nM - fm) : WGM;
        u.pm = fm + ((wgid % nig) % gsz); u.pn = (wgid % nig) / gsz; return true;
    }
    __device__ __forceinline__ void a_ready(const Unit&) const {}
    __device__ __forceinline__ void done(const Unit&) const {}
};

typedef float cvt_f32x2 __attribute__((ext_vector_type(2))); typedef __bf16 cvt_bf16x2 __attribute__((ext_vector_type(2)));
__device__ __forceinline__ unsigned cvt_pk_bf16(float lo, float hi) { cvt_f32x2 v = {lo, hi}; cvt_bf16x2 b = __builtin_convertvector(v, cvt_bf16x2); return __builtin_bit_cast(unsigned, b); }
typedef float f32x2 __attribute__((ext_vector_type(2)));
__device__ __forceinline__ f32x2 gelu_pk(f32x2 v) {
    const f32x2 av = __builtin_elementwise_abs(v), d = av * 0.2316418882f + 1.0f;
    f32x2 t; t.x = __builtin_amdgcn_rcpf(d.x); t.y = __builtin_amdgcn_rcpf(d.y);
    f32x2 q = t * 0.5307027145f + (-0.7265760135f); q = q * t + 0.7107068705f; q = q * t + (-0.142248368f); q = q * t + 0.127414796f; q = q * t;
    const f32x2 s = (v * v) * (-0.72134752044f);
    f32x2 e; e.x = __builtin_amdgcn_exp2f(s.x); e.y = __builtin_amdgcn_exp2f(s.y);
    const f32x2 m = v * (q * e), r = v - m;
    f32x2 o; o.x = v.x < 0.f ? m.x : r.x; o.y = v.y < 0.f ? m.y : r.y; return o;
}

template <int ACT  > struct EpiBf16 {
    static constexpr bool PERM = true, AFTER_DRAIN = false; static_assert(ACT == 0 || ACT == 1, "EpiBf16: ACT is 0 (none) or 1 (gelu_pk)");
    bf16_t* O; int ldc; const float* bias; int split_cols; size_t split_stride; float scale0;
    __device__ __forceinline__ void operator()(const f32x4 (&acc)[2][2][4][2], const Unit& u, int wr, int wc, int fr, int fq) const {
        const int row0 = u.pm * BM + wr * 64 + fr; int colt = u.pn * BM; bf16_t* base = O;
        float sc = 1.f; if (split_cols) { const int t = colt / split_cols; base += (size_t)t * split_stride; colt -= t * split_cols; if (t == 0) sc = scale0; }
        const int col0 = colt + wc * 32 + 8 * fq, bcol0 = u.pn * BM + wc * 32 + 8 * fq;
        f32x4 bv[2][2];
#pragma unroll
        for (int bj = 0; bj < 2; ++bj)
#pragma unroll
            for (int n = 0; n < 2; ++n) bv[bj][n] = bias ? *(const f32x4*)(bias + bcol0 + bj * HALF + 4 * n) : (f32x4){0.f, 0.f, 0.f, 0.f};
#pragma unroll
        for (int ai = 0; ai < 2; ++ai)
#pragma unroll
            for (int m = 0; m < 4; ++m) { bf16_t* rowp = base + (size_t)(row0 + ai * HALF + m * 16) * ldc + col0;
#pragma unroll
                for (int bj = 0; bj < 2; ++bj) { f32x4 v0 = acc[ai][bj][m][0] + bv[bj][0], v1 = acc[ai][bj][m][1] + bv[bj][1];
                    if (ACT == 1) { f32x2 a = gelu_pk((f32x2){v0[0], v0[1]}), b = gelu_pk((f32x2){v0[2], v0[3]}), c = gelu_pk((f32x2){v1[0], v1[1]}), d = gelu_pk((f32x2){v1[2], v1[3]});
                        v0 = (f32x4){a.x, a.y, b.x, b.y}; v1 = (f32x4){c.x, c.y, d.x, d.y}; }
                    v0 = v0 * sc; v1 = v1 * sc; u32x4 w; w.x = cvt_pk_bf16(v0[0], v0[1]); w.y = cvt_pk_bf16(v0[2], v0[3]); w.z = cvt_pk_bf16(v1[0], v1[1]); w.w = cvt_pk_bf16(v1[2], v1[3]);
                    *(u32x4*)(rowp + bj * HALF) = w; } }
    }
};
struct XccOrder {
    int t0, nt, nN, nloc, rank;
    __device__ __forceinline__ bool next(int i, Unit& u) const { const int L = i * nloc + rank; if (L >= nt * nN) return false; u.pm = t0 + (L % nt); u.pn = L / nt; return true; }
    __device__ __forceinline__ void a_ready(const Unit&) const {}
    __device__ __forceinline__ void done(const Unit&) const {}
};
typedef unsigned u32x2 __attribute__((ext_vector_type(2)));
__device__ __forceinline__ float bf_lo(unsigned w) { return __uint_as_float(w << 16); }
__device__ __forceinline__ float bf_hi(unsigned w) { return __uint_as_float(w & 0xffff0000u); }
__device__ __forceinline__ float sigmoid_f(float x) { return __builtin_amdgcn_rcpf(1.0f + __builtin_amdgcn_exp2f(-1.4426950408889634f * x)); }

struct EpiProj {
    static constexpr bool PERM = true, AFTER_DRAIN = false;
    bf16_t* QKV; bf16_t* GATES; const float* b_gate;
    __device__ __forceinline__ void operator()(const f32x4 (&acc)[2][2][4][2], const Unit& u, int wr, int wc, int fr, int fq) const {
        const int row0 = u.pm * BM + wr * 64 + fr; const int colt = u.pn * BM;
        if (colt < 3072) {
            const int col0 = colt + wc * 32 + 8 * fq;
#pragma unroll
            for (int ai = 0; ai < 2; ++ai)
#pragma unroll
                for (int m = 0; m < 4; ++m) { bf16_t* rowp = QKV + (size_t)(row0 + ai * HALF + m * 16) * 3072 + col0;
#pragma unroll
                    for (int bj = 0; bj < 2; ++bj) { const f32x4 v0 = acc[ai][bj][m][0], v1 = acc[ai][bj][m][1];
                        u32x4 w; w.x = cvt_pk_bf16(v0[0], v0[1]); w.y = cvt_pk_bf16(v0[2], v0[3]); w.z = cvt_pk_bf16(v1[0], v1[1]); w.w = cvt_pk_bf16(v1[2], v1[3]);
                        *(u32x4*)(rowp + bj * HALF) = w; } }
        } else {
            const int col0 = colt - 3072 + wc * 32 + 8 * fq;
            f32x4 bv[2][2];
#pragma unroll
            for (int bj = 0; bj < 2; ++bj)
#pragma unroll
                for (int n = 0; n < 2; ++n) bv[bj][n] = *(const f32x4*)(b_gate + col0 + bj * HALF + 4 * n);
#pragma unroll
            for (int ai = 0; ai < 2; ++ai)
#pragma unroll
                for (int m = 0; m < 4; ++m) { bf16_t* rowp = GATES + (size_t)(row0 + ai * HALF + m * 16) * 2048 + col0;
#pragma unroll
                    for (int bj = 0; bj < 2; ++bj) { f32x4 v0 = acc[ai][bj][m][0] + bv[bj][0], v1 = acc[ai][bj][m][1] + bv[bj][1];
#ifndef DBG_RAW_GATES
#pragma unroll
                        for (int e = 0; e < 4; ++e) { v0[e] = sigmoid_f(v0[e]); v1[e] = sigmoid_f(v1[e]); }
#else
                        v0 = acc[ai][bj][m][0]; v1 = acc[ai][bj][m][1];
#endif
                        u32x4 w; w.x = cvt_pk_bf16(v0[0], v0[1]); w.y = cvt_pk_bf16(v0[2], v0[3]); w.z = cvt_pk_bf16(v1[0], v1[1]); w.w = cvt_pk_bf16(v1[2], v1[3]);
                        *(u32x4*)(rowp + bj * HALF) = w; } }
        }
    }
};

struct EpiSwiGLU {
    static constexpr bool PERM = true, AFTER_DRAIN = false;
    bf16_t* HM; int ldc;
    __device__ __forceinline__ void operator()(const f32x4 (&acc)[2][2][4][2], const Unit& u, int wr, int wc, int fr, int fq) const {
        const int row0 = u.pm * BM + wr * 64 + fr; const int col0 = u.pn * HALF + wc * 32 + 8 * fq;
#pragma unroll
        for (int ai = 0; ai < 2; ++ai)
#pragma unroll
            for (int m = 0; m < 4; ++m) { bf16_t* rowp = HM + (size_t)(row0 + ai * HALF + m * 16) * ldc + col0;
                f32x4 v0 = acc[ai][0][m][0], v1 = acc[ai][0][m][1]; const f32x4 u0 = acc[ai][1][m][0], u1 = acc[ai][1][m][1];
#pragma unroll
                for (int e = 0; e < 4; ++e) { v0[e] = v0[e] * sigmoid_f(v0[e]) * u0[e]; v1[e] = v1[e] * sigmoid_f(v1[e]) * u1[e]; }
                u32x4 w; w.x = cvt_pk_bf16(v0[0], v0[1]); w.y = cvt_pk_bf16(v0[2], v0[3]); w.z = cvt_pk_bf16(v1[0], v1[1]); w.w = cvt_pk_bf16(v1[2], v1[3]);
                *(u32x4*)rowp = w; }
    }
};

struct EpiGate1 {
    static constexpr bool PERM = false, AFTER_DRAIN = false;
    const bf16_t* GATES; float* T;
    __device__ __forceinline__ void operator()(const f32x4 (&acc)[2][2][4][2], const Unit& u, int wr, int wc, int fr, int fq) const {
        const int row0 = u.pm * BM + wr * 64 + fr; const int col0 = u.pn * BM + wc * 32 + 4 * fq;
#pragma unroll
        for (int ai = 0; ai < 2; ++ai)
#pragma unroll
            for (int m = 0; m < 4; ++m) { const size_t r = (size_t)(row0 + ai * HALF + m * 16);
#pragma unroll
                for (int bj = 0; bj < 2; ++bj)
#pragma unroll
                    for (int n = 0; n < 2; ++n) { const int c = col0 + bj * HALF + n * 16; const u32x2 g = *(const u32x2*)(GATES + r * 2048 + c); const f32x4 a = acc[ai][bj][m][n];
                        f32x4 o; o[0] = bf_lo(g.x) * a[0]; o[1] = bf_hi(g.x) * a[1]; o[2] = bf_lo(g.y) * a[2]; o[3] = bf_hi(g.y) * a[3];
#ifdef DBG_GSB
                        o = o * DBG_GSB;
#endif
                        *(f32x4*)(T + r * 1024 + c) = o; }
                asm volatile("" ::: "memory"); }
    }
};
struct EpiGate2 {
    static constexpr bool PERM = false, AFTER_DRAIN = false;
    const bf16_t* GATES; const float* T; bf16_t* MIX;
    __device__ __forceinline__ void operator()(const f32x4 (&acc)[2][2][4][2], const Unit& u, int wr, int wc, int fr, int fq) const {
        const int row0 = u.pm * BM + wr * 64 + fr; const int col0 = u.pn * BM + wc * 32 + 4 * fq;
#pragma unroll
        for (int ai = 0; ai < 2; ++ai)
#pragma unroll
            for (int m = 0; m < 4; ++m) { const size_t r = (size_t)(row0 + ai * HALF + m * 16);
#pragma unroll
                for (int bj = 0; bj < 2; ++bj)
#pragma unroll
                    for (int n = 0; n < 2; ++n) { const int c = col0 + bj * HALF + n * 16; const u32x2 g = *(const u32x2*)(GATES + r * 2048 + 1024 + c); const f32x4 a = acc[ai][bj][m][n];
                        const f32x4 t = *(const f32x4*)(T + r * 1024 + c);
                        #ifndef DBG_GFX
#define DBG_GFX 1.0f
#endif
                        u32x2 w; w.x = cvt_pk_bf16(t[0] + DBG_GFX * bf_lo(g.x) * a[0], t[1] + DBG_GFX * bf_hi(g.x) * a[1]); w.y = cvt_pk_bf16(t[2] + DBG_GFX * bf_lo(g.y) * a[2], t[3] + DBG_GFX * bf_hi(g.y) * a[3]);
                        *(u32x2*)(MIX + r * 1024 + c) = w; }
                asm volatile("" ::: "memory"); }
    }
};
struct EpiRes {
    static constexpr bool PERM = false, AFTER_DRAIN = false;
    const float* base; const float* gvec; float* OUT; float alpha; float gscale;
    __device__ __forceinline__ void operator()(const f32x4 (&acc)[2][2][4][2], const Unit& u, int wr, int wc, int fr, int fq) const {
        const int row0 = u.pm * BM + wr * 64 + fr; const int col0 = u.pn * BM + wc * 32 + 4 * fq;
        const float* gv = gvec + (size_t)(u.pm >> 4) * 6144;
        f32x4 g[2][2];
#pragma unroll
        for (int bj = 0; bj < 2; ++bj)
#pragma unroll
            for (int n = 0; n < 2; ++n) { f32x4 s = *(const f32x4*)(gv + col0 + bj * HALF + n * 16);
#pragma unroll
                for (int i = 1; i < 8; ++i) s += *(const f32x4*)(gv + (size_t)i * 4 * 6144 + col0 + bj * HALF + n * 16);
                g[bj][n] = s; }
#pragma unroll
        for (int ai = 0; ai < 2; ++ai)
#pragma unroll
            for (int m = 0; m < 4; ++m) { const size_t r = (size_t)(row0 + ai * HALF + m * 16);
#pragma unroll
                for (int bj = 0; bj < 2; ++bj)
#pragma unroll
                    for (int n = 0; n < 2; ++n) { const int c = col0 + bj * HALF + n * 16; const f32x4 bs = *(const f32x4*)(base + r * 1024 + c);
                        *(f32x4*)(OUT + r * 1024 + c) = bs * alpha + g[bj][n] * acc[ai][bj][m][n] * gscale; }
                asm volatile("" ::: "memory"); }
    }
};

struct EpiGateDiff {
    static constexpr bool PERM = false, AFTER_DRAIN = false;
    const bf16_t* GATES; float* T; float scale;
    __device__ __forceinline__ void operator()(const f32x4 (&acc)[2][2][4][2], const Unit& u, int wr, int wc, int fr, int fq) const {
        const int row0 = u.pm * BM + wr * 64 + fr; const int col0 = u.pn * BM + wc * 32 + 4 * fq;
#pragma unroll
        for (int ai = 0; ai < 2; ++ai)
#pragma unroll
            for (int m = 0; m < 4; ++m) { const size_t r = (size_t)(row0 + ai * HALF + m * 16);
#pragma unroll
                for (int bj = 0; bj < 2; ++bj)
#pragma unroll
                    for (int n = 0; n < 2; ++n) { const int c = col0 + bj * HALF + n * 16; const u32x2 g = *(const u32x2*)(GATES + r * 2048 + c); const f32x4 a = acc[ai][bj][m][n];
                        f32x4 o; o[0] = bf_lo(g.x) * a[0]; o[1] = bf_hi(g.x) * a[1]; o[2] = bf_lo(g.y) * a[2]; o[3] = bf_hi(g.y) * a[3];
                        const f32x4 t = *(const f32x4*)(T + r * 1024 + c);
                        *(f32x4*)(T + r * 1024 + c) = (o - t) * scale; } }
    }
};
template <class Epi, class Sched, bool ALIGN_EPI = false, bool SP2 = false>
__device__ __forceinline__ void gemm_phase(PG8_LAS unsigned char* lds, const Gemm g, const Sched& S, const Epi& E) {
    int tid_ = threadIdx.x; asm volatile("" : "+v"(tid_));
    const int tid = tid_, wid = __builtin_amdgcn_readfirstlane(tid >> 6), lane = tid & 63, wr = wid >> 2, wc = wid & 3, fr = lane & 15, fq = lane >> 4;
    const int K = g.K, nt = K / BK;
    unsigned voffA[2], voffB[2];
#pragma unroll
    for (int i = 0; i < 2; ++i) { int R, C; stage_rc(tid * 16 + i * 8192, R, C); const int Rb = Epi::PERM ? ((R & ~31) + perm32(R & 31)) : R;
        voffA[i] = (unsigned)(R * K + C) * 2u; voffB[i] = (unsigned)(Rb * K + C) * 2u; }
    const size_t kstep = (size_t)(BK * 2);
    const size_t hstep = (size_t)HALF * K * 2;
    const size_t tstep = 2 * hstep;
    const unsigned ldsw = (unsigned)wid * 1024u;
    const int aoff = lds_byte(wr * 64 + fr, fq * 8), boff = lds_byte(wc * 32 + fr, fq * 8);
#define PG8_SA(b, h) (((b) * 2 + (h)) * HTB)
#define PG8_SB(b, h) ((4 + (b) * 2 + (h)) * HTB)
#define PG8_STAGE(bufoff, gbase, voff) do { _Pragma("unroll") for (int _i = 0; _i < 2; ++_i) \
        __builtin_amdgcn_global_load_lds((const unsigned*)((const char*)(gbase) + (voff)[_i]), (PG8_LAS unsigned*)(lds + (bufoff) + ldsw + _i * 8192), 16, 0, 0); } while (0)
#define PG8_LDA(dst, b, h) do { _Pragma("unroll") for (int m = 0; m < 4; ++m) _Pragma("unroll") for (int k = 0; k < 2; ++k) dst[m][k] = *(const PG8_LAS bf16x8*)(lds + PG8_SA(b, h) + aoff + m * 2048 + k * 1024); } while (0)
#define PG8_LDB(dst, b, h) do { _Pragma("unroll") for (int n = 0; n < 2; ++n) _Pragma("unroll") for (int k = 0; k < 2; ++k) dst[n][k] = *(const PG8_LAS bf16x8*)(lds + PG8_SB(b, h) + boff + n * 2048 + k * 1024); } while (0)
#define PG8_MMA(ai, bj, At, Bt) do { __builtin_amdgcn_s_setprio(1); _Pragma("unroll") for (int m = 0; m < 4; ++m) _Pragma("unroll") for (int n = 0; n < 2; ++n) _Pragma("unroll") for (int k = 0; k < 2; ++k) \
        acc[ai][bj][m][n] = __builtin_amdgcn_mfma_f32_16x16x32_bf16(Bt[n][k], At[m][k], acc[ai][bj][m][n], 0, 0, 0); __builtin_amdgcn_s_setprio(0); } while (0)
#define PG8_WAIT_V(n) asm volatile("s_waitcnt vmcnt(" #n ")" ::: "memory")
#define PG8_WAIT_L(n) asm volatile("s_waitcnt lgkmcnt(" #n ")" ::: "memory")
#define PG8_BAR __builtin_amdgcn_s_barrier()
#define PG8_SCHED __builtin_amdgcn_sched_barrier(0)
    Unit cur, nxt; int ui = 0;
    if (!S.next(0, cur)) return;
    f32x4 acc[2][2][4][2];
#pragma unroll
    for (int a = 0; a < 2; ++a)
#pragma unroll
        for (int b = 0; b < 2; ++b)
#pragma unroll
            for (int m = 0; m < 4; ++m)
#pragma unroll
                for (int n = 0; n < 2; ++n) acc[a][b][m][n] = (f32x4){0.f, 0.f, 0.f, 0.f};
    bf16x8 At[4][2], B0[2][2], B1[2][2];
    const char* cA = (const char*)g.A + (size_t)cur.pm * tstep; const char* cB = (const char*)g.Bt + (size_t)cur.pn * tstep;
    S.a_ready(cur);
    if constexpr (SP2) {
        PG8_STAGE(PG8_SB(0, 0), cB, voffB); PG8_STAGE(PG8_SB(0, 1), cB + hstep, voffB); PG8_STAGE(PG8_SA(0, 0), cA, voffA); PG8_STAGE(PG8_SA(0, 1), cA + hstep, voffA);
        if (wr == 1) PG8_BAR;
        PG8_WAIT_V(2); PG8_BAR;
        PG8_STAGE(PG8_SB(1, 0), cB + kstep, voffB); PG8_STAGE(PG8_SA(1, 0), cA + kstep, voffA); PG8_STAGE(PG8_SB(1, 1), cB + hstep + kstep, voffB);
        PG8_WAIT_V(6); PG8_BAR;
    } else {
        PG8_STAGE(PG8_SB(0, 0), cB, voffB); PG8_STAGE(PG8_SA(0, 0), cA, voffA); PG8_STAGE(PG8_SB(0, 1), cB + hstep, voffB); PG8_STAGE(PG8_SA(0, 1), cA + hstep, voffA);
        if (wr == 1) PG8_BAR;
        PG8_WAIT_V(4); PG8_BAR;
        PG8_STAGE(PG8_SB(1, 0), cB + kstep, voffB); PG8_STAGE(PG8_SA(1, 0), cA + kstep, voffA); PG8_STAGE(PG8_SB(1, 1), cB + hstep + kstep, voffB);
        PG8_WAIT_V(6); PG8_BAR;
    }
    for (;;) {
        const bool has_next = S.next(ui + 1, nxt);
        const char* nA = has_next ? (const char*)g.A + (size_t)nxt.pm * tstep : cA; const char* nB = has_next ? (const char*)g.Bt + (size_t)nxt.pn * tstep : cB;
        for (int t = 0; t < nt; t += 2) {
            const bool last = (t == nt - 2);
            const char* a1 = cA + (size_t)(t + 1) * kstep;
            const char* a2 = last ? nA : cA + (size_t)(t + 2) * kstep; const char* b2 = last ? nB : cB + (size_t)(t + 2) * kstep;
            const char* a3 = a2 + kstep; const char* b3 = b2 + kstep;
            if (last && has_next) S.a_ready(nxt);
            if constexpr (SP2) {
            PG8_LDB(B0, 0, 0); PG8_LDB(B1, 0, 1); PG8_SCHED; PG8_LDA(At, 0, 0); PG8_STAGE(PG8_SA(1, 1), a1 + hstep, voffA);
            PG8_WAIT_V(8); PG8_WAIT_L(0); PG8_BAR; PG8_MMA(0, 0, At, B0); PG8_MMA(0, 1, At, B1); PG8_BAR; PG8_SCHED;
            PG8_LDA(At, 0, 1); PG8_STAGE(PG8_SB(0, 0), b2, voffB); PG8_STAGE(PG8_SB(0, 1), b2 + hstep, voffB); PG8_STAGE(PG8_SA(0, 0), a2, voffA);
            PG8_WAIT_V(8); PG8_WAIT_L(0); PG8_BAR; PG8_MMA(1, 0, At, B0); PG8_MMA(1, 1, At, B1); PG8_BAR; PG8_SCHED;
            PG8_LDB(B0, 1, 0); PG8_LDB(B1, 1, 1); PG8_SCHED; PG8_LDA(At, 1, 0); PG8_STAGE(PG8_SA(0, 1), a2 + hstep, voffA);
            PG8_WAIT_V(8); PG8_WAIT_L(0); PG8_BAR; PG8_MMA(0, 0, At, B0); PG8_MMA(0, 1, At, B1); PG8_BAR; PG8_SCHED;
            PG8_LDA(At, 1, 1); PG8_STAGE(PG8_SB(1, 0), b3, voffB); PG8_STAGE(PG8_SB(1, 1), b3 + hstep, voffB); PG8_STAGE(PG8_SA(1, 0), a3, voffA);
            PG8_WAIT_V(8); PG8_WAIT_L(0); PG8_BAR; PG8_MMA(1, 0, At, B0); PG8_MMA(1, 1, At, B1); PG8_BAR; PG8_SCHED;
            } else {
            PG8_LDB(B0, 0, 0); PG8_SCHED; PG8_LDA(At, 0, 0); PG8_STAGE(PG8_SA(1, 1), a1 + hstep, voffA);
            PG8_WAIT_L(8); PG8_BAR; PG8_WAIT_L(0); PG8_MMA(0, 0, At, B0); PG8_BAR; PG8_SCHED;
            PG8_LDB(B1, 0, 1); PG8_STAGE(PG8_SB(0, 0), b2, voffB);
            PG8_BAR; PG8_WAIT_L(0); PG8_MMA(0, 1, At, B1); PG8_BAR;
            PG8_LDA(At, 0, 1); PG8_STAGE(PG8_SA(0, 0), a2, voffA);
            PG8_BAR; PG8_WAIT_L(0); PG8_MMA(1, 0, At, B0); PG8_BAR; PG8_SCHED;
            PG8_STAGE(PG8_SB(0, 1), b2 + hstep, voffB);
            PG8_WAIT_V(6); PG8_BAR; PG8_MMA(1, 1, At, B1); PG8_BAR;
            PG8_LDB(B0, 1, 0); PG8_SCHED; PG8_LDA(At, 1, 0); PG8_STAGE(PG8_SA(0, 1), a2 + hstep, voffA);
            PG8_WAIT_L(8); PG8_BAR; PG8_WAIT_L(0); PG8_MMA(0, 0, At, B0); PG8_BAR; PG8_SCHED;
            PG8_LDB(B1, 1, 1); PG8_STAGE(PG8_SB(1, 0), b3, voffB);
            PG8_BAR; PG8_WAIT_L(0); PG8_MMA(0, 1, At, B1); PG8_BAR;
            PG8_LDA(At, 1, 1); PG8_STAGE(PG8_SA(1, 0), a3, voffA);
            PG8_BAR; PG8_WAIT_L(0); PG8_MMA(1, 0, At, B0); PG8_BAR; PG8_SCHED;
            PG8_STAGE(PG8_SB(1, 1), b3 + hstep, voffB);
            PG8_WAIT_V(6); PG8_BAR; PG8_MMA(1, 1, At, B1); PG8_BAR;
            }
        }
        if constexpr (ALIGN_EPI) { if (wr == 0) PG8_BAR; }
        if constexpr (!Epi::AFTER_DRAIN) { E(acc, cur, wr, wc, fr, fq); S.done(cur); }
        if (!has_next) break;
#pragma unroll
        for (int a = 0; a < 2; ++a)
#pragma unroll
            for (int b = 0; b < 2; ++b)
#pragma unroll
                for (int m = 0; m < 4; ++m)
#pragma unroll
                    for (int n = 0; n < 2; ++n) acc[a][b][m][n] = (f32x4){0.f, 0.f, 0.f, 0.f};
        cur = nxt; cA = nA; cB = nB; ++ui;
        if constexpr (ALIGN_EPI) { if (wr == 1) PG8_BAR; }
    }
    PG8_WAIT_V(0);
    if constexpr (!ALIGN_EPI) { if (wr == 0) PG8_BAR; }
    PG8_BAR;
    if constexpr (Epi::AFTER_DRAIN) { E.fused(acc, cur, wr, wc, fr, fq, lds, wid, lane); S.done(cur); }
#undef PG8_SA
#undef PG8_SB
#undef PG8_STAGE
#undef PG8_LDA
#undef PG8_LDB
#undef PG8_MMA
#undef PG8_WAIT_V
#undef PG8_WAIT_L
#undef PG8_BAR
#undef PG8_SCHED
}
}
namespace att {
#define ALAS __attribute__((address_space(3)))
typedef unsigned short bf16_t;
typedef short bf16x8 __attribute__((ext_vector_type(8)));
typedef short s16x4 __attribute__((ext_vector_type(4)));
typedef float f32x16 __attribute__((ext_vector_type(16)));
typedef float f32x4 __attribute__((ext_vector_type(4)));
typedef unsigned u32x4 __attribute__((ext_vector_type(4)));
typedef unsigned u32x2 __attribute__((ext_vector_type(2)));
typedef float f32x2_t __attribute__((ext_vector_type(2)));
typedef __bf16 bf16x2_t __attribute__((ext_vector_type(2)));
constexpr int SEQ = 4096, LDQ = 3072;
constexpr int KSTR = 144, KT = 64 * KSTR, VT = 8192;
constexpr int OFF_K = 0, OFF_V = 2 * KT, OFF_F = OFF_V + 2 * VT, OFF_FLAG = OFF_F + 512, LDS_NEED = OFF_FLAG + 64;
constexpr float LOG2E = 1.4426950408889634f, C2 = 0.125f * LOG2E;
constexpr float SB_DONE = 151.0f;
#define ADI __device__ __forceinline__
ADI unsigned cvtpk(float lo, float hi) { f32x2_t v = {lo, hi}; bf16x2_t b = __builtin_convertvector(v, bf16x2_t); return __builtin_bit_cast(unsigned, b); }
ADI s16x4 vtr(const ALAS unsigned char* p) { typedef short v4i16_t __attribute__((ext_vector_type(4))); return __builtin_bit_cast(s16x4, __builtin_amdgcn_ds_read_tr16_b64_v4i16((ALAS v4i16_t*)p)); }
ADI float half_max(float v) { auto rr = __builtin_amdgcn_permlane32_swap(__float_as_uint(v), __float_as_uint(v), false, false); return fmaxf(__uint_as_float(rr[0]), __uint_as_float(rr[1])); }
ADI float half_sum(float v) { auto rr = __builtin_amdgcn_permlane32_swap(__float_as_uint(v), __float_as_uint(v), false, false); return __uint_as_float(rr[0]) + __uint_as_float(rr[1]); }

template <int MODE, bool MASK>
ADI void tile(const ALAS unsigned char* Kb, const ALAS unsigned char* Vb, const ALAS float* Fb, const bf16x8 (&qf)[4], f32x16 (&O)[2],
              float& m, float& l, float& R, float Fq2, int kaddr, int vaddr, int hf, int q, int key0) {
    f32x16 S[2];
#pragma unroll
    for (int kb = 0; kb < 2; ++kb) {
#pragma unroll
        for (int r = 0; r < 16; ++r) S[kb][r] = 0.f;
#pragma unroll
        for (int d0 = 0; d0 < 4; ++d0) { const bf16x8 kf = *(const ALAS bf16x8*)(Kb + kaddr + kb * 32 * KSTR + d0 * 32);
            S[kb] = __builtin_amdgcn_mfma_f32_32x32x16_bf16(kf, qf[d0], S[kb], 0, 0, 0); }
    }
    if (MODE == 0) {
#pragma unroll
        for (int kb = 0; kb < 2; ++kb)
#pragma unroll
            for (int a = 0; a < 2; ++a) { const f32x4 f0 = *(const ALAS f32x4*)(Fb + 32 * kb + 16 * a + 8 * hf), f1 = *(const ALAS f32x4*)(Fb + 32 * kb + 16 * a + 8 * hf + 4);
#pragma unroll
                for (int e = 0; e < 4; ++e) { S[kb][8 * a + e] = fmaf(S[kb][8 * a + e], C2, Fq2 - f0[e]); S[kb][8 * a + 4 + e] = fmaf(S[kb][8 * a + 4 + e], C2, Fq2 - f1[e]); } }
        if (MASK) {
#pragma unroll
            for (int kb = 0; kb < 2; ++kb)
#pragma unroll
                for (int r = 0; r < 16; ++r) { const int keyg = key0 + 32 * kb + 16 * (r >> 3) + 8 * hf + (r & 7); if (keyg > q) S[kb][r] = -INFINITY; }
        }
        float mx = S[0][0];
#pragma unroll
        for (int r = 1; r < 16; ++r) mx = fmaxf(mx, S[0][r]);
#pragma unroll
        for (int r = 0; r < 16; ++r) mx = fmaxf(mx, S[1][r]);
        mx = half_max(mx);
        const float mn = fmaxf(m, mx), alpha = __builtin_amdgcn_exp2f(m - mn); m = mn;
        float ps = 0.f;
#pragma unroll
        for (int kb = 0; kb < 2; ++kb)
#pragma unroll
            for (int r = 0; r < 16; ++r) { const float p = __builtin_amdgcn_exp2f(S[kb][r] - mn); S[kb][r] = p; ps += p; }
        l = l * alpha + ps;
#pragma unroll
        for (int d0 = 0; d0 < 2; ++d0)
#pragma unroll
            for (int r = 0; r < 16; ++r) O[d0][r] *= alpha;
    } else {
        f32x16 P[2];
#pragma unroll
        for (int kb = 0; kb < 2; ++kb)
#pragma unroll
            for (int r = 0; r < 16; ++r) { const float z = S[kb][r] * C2; S[kb][r] = z;
                float sp = fmaxf(z, 0.f) + __builtin_amdgcn_logf(1.0f + __builtin_amdgcn_exp2f(-fabsf(z)));
                if (MASK) { const int keyg = key0 + 32 * kb + 16 * (r >> 3) + 8 * hf + (r & 7); if (keyg >= q) sp = 0.f; }
                P[kb][r] = sp; }
        float T[4], PT[4];
#pragma unroll
        for (int kb = 0; kb < 2; ++kb)
#pragma unroll
            for (int a = 0; a < 2; ++a) { float run = 0.f;
#pragma unroll
                for (int e = 7; e >= 0; --e) { run += P[kb][8 * a + e]; P[kb][8 * a + e] = run; }
                T[2 * kb + a] = run; }
#pragma unroll
        for (int i = 0; i < 4; ++i) PT[i] = __shfl_xor(T[i], 32);
        float acc_hi = R;
#pragma unroll
        for (int mi = 3; mi >= 0; --mi) { const int kb = mi >> 1, a = mi & 1; const float off = acc_hi + (hf == 0 ? PT[mi] : 0.f);
#pragma unroll
            for (int e = 0; e < 8; ++e) { const int r = 8 * a + e; float w = __builtin_amdgcn_exp2f(S[kb][r] - (P[kb][r] + off));
                if (MASK) { const int keyg = key0 + 32 * kb + 16 * a + 8 * hf + e; if (keyg >= q) w = 0.f; }
                S[kb][r] = w; }
            acc_hi += T[mi] + PT[mi]; }
        R = acc_hi;
    }
    bf16x8 pf[4];
#pragma unroll
    for (int kb = 0; kb < 2; ++kb)
#pragma unroll
        for (int a = 0; a < 2; ++a) { u32x4 w; w.x = cvtpk(S[kb][8 * a + 0], S[kb][8 * a + 1]); w.y = cvtpk(S[kb][8 * a + 2], S[kb][8 * a + 3]); w.z = cvtpk(S[kb][8 * a + 4], S[kb][8 * a + 5]); w.w = cvtpk(S[kb][8 * a + 6], S[kb][8 * a + 7]);
            pf[2 * kb + a] = __builtin_bit_cast(bf16x8, w); }
#pragma unroll
    for (int d0 = 0; d0 < 2; ++d0)
#pragma unroll
        for (int ks = 0; ks < 4; ++ks) { const s16x4 lo = vtr(Vb + vaddr + d0 * 4096 + ks * 1024), hi = vtr(Vb + vaddr + d0 * 4096 + ks * 1024 + 256);
            const bf16x8 vf = {lo[0], lo[1], lo[2], lo[3], hi[0], hi[1], hi[2], hi[3]};
            O[d0] = __builtin_amdgcn_mfma_f32_32x32x16_bf16(vf, pf[ks], O[d0], 0, 0, 0); }
}

template <int MODE>
ADI void attn_unit(ALAS unsigned char* lds, const bf16_t* __restrict__ QKV, int qcol, int kcol, int vcol, const float* __restrict__ Fseq, bf16_t* __restrict__ AO, int b, int h, int qb) {
    const int tid = threadIdx.x, lane = tid & 63, r32 = lane & 31, hf = lane >> 5; const int wid = __builtin_amdgcn_readfirstlane(tid >> 6);
    const size_t rowbase = (size_t)b * SEQ;
    const int qw0 = qb * 256 + wid * 32, q = qw0 + r32;
    bf16x8 qf[4];
    { const bf16_t* qp = QKV + (rowbase + q) * LDQ + qcol + h * 64 + hf * 8;
#pragma unroll
      for (int d0 = 0; d0 < 4; ++d0) qf[d0] = *(const bf16x8*)(qp + d0 * 16); }
    const float Fq2 = (MODE == 0) ? Fseq[q] * LOG2E : 0.f;
    const int NT = 4 * qb + 4, tmax_w = (qw0 + 31) >> 6;
    const int lkey = tid >> 3, lch = tid & 7;
    const bf16_t* kg = QKV + (rowbase + lkey) * LDQ + kcol + h * 64 + lch * 8;
    const bf16_t* vg = QKV + (rowbase + lkey) * LDQ + vcol + h * 64 + lch * 8;
    const int kdst = lkey * KSTR + lch * 16, vdst = (lch >> 2) * 4096 + lkey * 64 + (lch & 3) * 16;
    const int kperm = (r32 & ~12) | ((r32 & 4) << 1) | ((r32 & 8) >> 1);
    const int kaddr = kperm * KSTR + hf * 16;
    const int vaddr = hf * 512 + ((lane & 15) >> 2) * 64 + ((lane >> 4) & 1) * 32 + (lane & 3) * 8;
    ALAS int* flags = (ALAS int*)(lds + OFF_FLAG);
    u32x4 kr, vr; float fr = 0.f;
    { const size_t go = (size_t)(NT - 1) * 64 * LDQ; kr = *(const u32x4*)(kg + go); vr = *(const u32x4*)(vg + go); if (MODE == 0 && tid < 64) fr = Fseq[(NT - 1) * 64 + tid] * LOG2E; }
    *(ALAS u32x4*)(lds + OFF_K + kdst) = kr; *(ALAS u32x4*)(lds + OFF_V + vdst) = vr; if (MODE == 0 && tid < 64) ((ALAS float*)(lds + OFF_F))[tid] = fr;
    if (MODE == 1 && tid < 8) flags[tid] = 0x7fffffff;
    __syncthreads();
    f32x16 O[2];
#pragma unroll
    for (int r = 0; r < 16; ++r) { O[0][r] = 0.f; O[1][r] = 0.f; }
    float m = -INFINITY, l = 0.f, R = 0.f; bool wdone = false;
    for (int i = 0; i < NT; ++i) {
        const int t = NT - 1 - i, cur = i & 1; const bool has_next = (i + 1 < NT);
        if (has_next) { const size_t go = (size_t)(t - 1) * 64 * LDQ; kr = *(const u32x4*)(kg + go); vr = *(const u32x4*)(vg + go); if (MODE == 0 && tid < 64) fr = Fseq[(t - 1) * 64 + tid] * LOG2E; }
        if (t <= tmax_w && !wdone) {
            const ALAS unsigned char* Kb = lds + OFF_K + cur * KT; const ALAS unsigned char* Vb = lds + OFF_V + cur * VT; const ALAS float* Fb = (const ALAS float*)(lds + OFF_F + cur * 256);
            if (64 * t + 63 >= qw0) tile<MODE, true>(Kb, Vb, Fb, qf, O, m, l, R, Fq2, kaddr, vaddr, hf, q, 64 * t);
            else tile<MODE, false>(Kb, Vb, Fb, qf, O, m, l, R, Fq2, kaddr, vaddr, hf, q, 64 * t);
            if (MODE == 1) { if (__all(R >= SB_DONE) || t == 0) { wdone = true; if (lane == 0) flags[wid] = i; } }
        }
        if (has_next) { const int nx = cur ^ 1; *(ALAS u32x4*)(lds + OFF_K + nx * KT + kdst) = kr; *(ALAS u32x4*)(lds + OFF_V + nx * VT + vdst) = vr; if (MODE == 0 && tid < 64) ((ALAS float*)(lds + OFF_F + nx * 256))[tid] = fr; }
        __syncthreads();
        if (MODE == 1) { bool all_done = true;
#pragma unroll
            for (int w = 0; w < 8; ++w) all_done = all_done && (flags[w] <= i);
            if (all_done) break; }
    }
    float inv = 1.0f;
    if (MODE == 0) { l = half_sum(l); inv = 1.0f / l; }
    bf16_t* op = AO + (rowbase + q) * 512 + h * 64 + 4 * hf;
#pragma unroll
    for (int d0 = 0; d0 < 2; ++d0)
#pragma unroll
        for (int g = 0; g < 4; ++g) { u32x2 w; w.x = cvtpk(O[d0][4 * g] * inv, O[d0][4 * g + 1] * inv); w.y = cvtpk(O[d0][4 * g + 2] * inv, O[d0][4 * g + 3] * inv);
            *(u32x2*)(op + 32 * d0 + 8 * g) = w; }
    __syncthreads();
}
#undef ADI
#undef ALAS
}
#define LAS __attribute__((address_space(3)))
typedef unsigned short bf16;
typedef float f32x4 __attribute__((ext_vector_type(4)));
typedef unsigned v4u __attribute__((ext_vector_type(4)));
typedef unsigned v2u __attribute__((ext_vector_type(2)));
constexpr int NWAVES = 8;
constexpr int BATCH = 4, SEQ = 4096, D = 1024, M = BATCH * SEQ, NHEAD = 8, FF = 2816, INC = 5128, NPROJ = 5120, NGU = 2 * FF, NCOND = 6 * D;
constexpr float LN_EPS = 1e-5f, ALPHA = 1.189207115002721f;
constexpr size_t MiB = 1u << 20;
constexpr size_t WS_ADA = 0;
constexpr size_t CTL_ZERO_BYTES = 16 * 1024;
constexpr size_t WS_BAR = 1000 * 1024;
constexpr size_t WS_F = 31 * MiB + 512 * 1024;
constexpr size_t WS_WIN = 1 * MiB, WS_WSB = 11 * MiB, WS_WFX = 12 * MiB, WS_WO = 13 * MiB, WS_WGU = 15 * MiB, WS_WDN = 26 * MiB;
constexpr size_t WS_U = 32 * MiB;
constexpr size_t WS_QKV = 64 * MiB;
constexpr size_t WS_GATES = 160 * MiB;
constexpr size_t WS_AOS = 224 * MiB, WS_AOF = 240 * MiB;
constexpr size_t WS_MIX = 64 * MiB;
constexpr size_t WS_X1 = 96 * MiB;
constexpr size_t WS_T = 96 * MiB;
constexpr size_t WS_R1 = 160 * MiB;
constexpr size_t WS_R2 = 32 * MiB;
constexpr size_t WS_HM = 160 * MiB;
constexpr size_t WS_END = 256 * MiB;
static_assert(WS_WDN + (size_t)D * FF * 2 <= WS_U && WS_HM + (size_t)M * FF * 2 <= WS_END && WS_X1 + (size_t)M * D * 4 <= WS_GATES, "d_ws map");
constexpr int LDS_BYTES = 132096;
static_assert(att::LDS_NEED <= 131072, "attention LDS");

#define DI __device__ __forceinline__
DI unsigned f2bf(float f) { unsigned u = __builtin_bit_cast(unsigned, f); return (u + 0x7fffu + ((u >> 16) & 1u)) >> 16; }
DI unsigned pk2(float lo, float hi) { return f2bf(lo) | (f2bf(hi) << 16); }
DI int opq(int v) { asm volatile("" : "+v"(v)); return v; }
DI float wave_sum(float v) {
#pragma unroll
    for (int o = 1; o < 64; o <<= 1) v += __shfl_xor(v, o);
    return v;
}
DI void transpose_item(const float* __restrict__ W, int ldw, int sc0, int k0, bf16* __restrict__ WT, int K, int dr0, LAS float* scr, int lane) {
#pragma unroll 8
    for (int i = 0; i < 32; ++i) { const int kk = 2 * i + (lane >> 5); scr[kk * 33 + (lane & 31)] = W[(size_t)(k0 + kk) * ldw + sc0 + (lane & 31)]; }
    asm volatile("s_waitcnt lgkmcnt(0)" ::: "memory");
    const int c = lane & 7;
#pragma unroll
    for (int j = 0; j < 4; ++j) { const int n = (lane >> 3) + 8 * j; const LAS float* s = scr + (8 * c) * 33 + n;
        v4u o; o.x = pk2(s[0 * 33], s[1 * 33]); o.y = pk2(s[2 * 33], s[3 * 33]); o.z = pk2(s[4 * 33], s[5 * 33]); o.w = pk2(s[6 * 33], s[7 * 33]);
        *(v4u*)(WT + (size_t)(dr0 + n) * K + k0 + 8 * c) = o; }
    asm volatile("s_waitcnt lgkmcnt(0)" ::: "memory");
}
DI float log_sigmoid_f(float x) { return fminf(x, 0.f) - log1pf(expf(-fabsf(x))); }

#define XB_TMO      128
#define XB_XCNT(j)  (256  + 64 * (j))
#define XB_XSUB(j)  (1280 + 64 * (j))
#define XB_XGEN(j)  (2304 + 64 * (j))
#define XB_TOP      3328
#define XB_TOPGEN   3392
#define XCD_BAR_WORDS 3456
#define XB_SPIN_CAP (1u << 18)

__device__ __forceinline__ unsigned xb_ld(unsigned* p)              { return __hip_atomic_load(p, __ATOMIC_RELAXED, __HIP_MEMORY_SCOPE_AGENT); }
__device__ __forceinline__ unsigned xb_add(unsigned* p, unsigned v) { return __hip_atomic_fetch_add(p, v, __ATOMIC_RELAXED, __HIP_MEMORY_SCOPE_AGENT); }
__device__ __forceinline__ unsigned xb_xcc_id() { return (unsigned)__builtin_amdgcn_s_getreg((3 << 11) | 20) & 0xFu; }
#define XB_SPIN(cond, bar) do { unsigned _sp = 0; while (cond) { __builtin_amdgcn_s_sleep(1); \
    if ((++_sp & 255u) == 0u) { if (xb_ld(&(bar)[XB_TMO])) break; if (_sp > XB_SPIN_CAP) { atomicAdd(&(bar)[XB_TMO], 1u); break; } } } } while (0)

struct XcdBarrier {
    unsigned* bar; unsigned x;
    volatile LAS unsigned* st;
};

__device__ __forceinline__ XcdBarrier xcd_barrier_post(unsigned* bar, volatile LAS unsigned* st) {
    XcdBarrier b; b.bar = bar; b.x = xb_xcc_id(); b.st = st;
    if (threadIdx.x == 0) (void)xb_add(&bar[XB_XCNT(b.x)], 1u);
    return b;
}
__device__ __forceinline__ void xcd_barrier_complete(unsigned* bar, unsigned x, unsigned& nloc, unsigned& nx) {
    const unsigned G = gridDim.x * gridDim.y * gridDim.z;
    unsigned sum, cnt, mine, sp = 0u;
    for (;;) {
        sum = 0u; cnt = 0u; mine = 0u;
#pragma unroll
        for (unsigned j = 0; j < 16; ++j) { const unsigned c = xb_ld(&bar[XB_XCNT(j)]); sum += c; cnt += (c > 0u) ? 1u : 0u; mine = (j == x) ? c : mine; }
        if (sum == G) break;
        __builtin_amdgcn_s_sleep(1);
        if ((++sp & 255u) == 0u) { if (xb_ld(&bar[XB_TMO])) break; if (sp > XB_SPIN_CAP) { atomicAdd(&bar[XB_TMO], 1u); break; } }
    }
    nloc = mine > 0u ? mine : 1u; nx = cnt > 0u ? cnt : 1u;
}

__device__ __forceinline__ void xcd_barrier(const XcdBarrier& b) {
    asm volatile("s_waitcnt vmcnt(0)" ::: "memory");
    __syncthreads();
    if (threadIdx.x == 0) {
        unsigned* bar = b.bar;
        __builtin_amdgcn_s_waitcnt(0);
        unsigned nloc = b.st[0], nx = b.st[1];
        if (nloc == 0u) { xcd_barrier_complete(bar, b.x, nloc, nx); b.st[0] = nloc; b.st[1] = nx; }
        const unsigned old = xb_add(&bar[XB_XSUB(b.x)], 1u);
        const unsigned gen = old / nloc;
        if (old + 1u == (gen + 1u) * nloc) {
            __builtin_amdgcn_fence(__ATOMIC_RELEASE, "agent");
            asm volatile("s_waitcnt vmcnt(0)" ::: "memory");
            const unsigned og = xb_add(&bar[XB_TOP], 1u);
            const unsigned tg = og / nx;
            if (og + 1u == (tg + 1u) * nx) xb_add(&bar[XB_TOPGEN], 1u);
            else XB_SPIN(xb_ld(&bar[XB_TOPGEN]) == tg, bar);
            __builtin_amdgcn_fence(__ATOMIC_ACQUIRE, "agent");
            xb_add(&bar[XB_XGEN(b.x)], 1u);
            asm volatile("s_waitcnt vmcnt(0)" ::: "memory");
        } else {
            XB_SPIN(xb_ld(&bar[XB_XGEN(b.x)]) == gen, bar);
            __builtin_amdgcn_fence(__ATOMIC_ACQUIRE, "agent");
            asm volatile("s_waitcnt vmcnt(0)" ::: "memory");
        }
    }
    __syncthreads();
}

constexpr int ADA_PSTRIDE = 4 * NCOND;
DI f32x4 ada4(const float* p) { f32x4 s = *(const f32x4*)p;
#pragma unroll
    for (int i = 1; i < 8; ++i) s += *(const f32x4*)(p + (size_t)i * ADA_PSTRIDE);
    return s; }

#ifdef DEBUG_NAIVE_ATTN
template <int MODE>
DI void naive_attn(const bf16* __restrict__ QKV, int qcol, int kcol, int vcol, const float* __restrict__ Fc, bf16* __restrict__ AO, int gthread) {
    const int t = gthread & 4095, bh = gthread >> 12, b = bh >> 3, h = bh & 7;
    const size_t rowbase = (size_t)b * SEQ;
    float q[64], o[64];
    { const bf16* qp = QKV + (rowbase + t) * 3072 + qcol + h * 64;
#pragma unroll
      for (int d = 0; d < 64; ++d) { q[d] = __uint_as_float((unsigned)qp[d] << 16); o[d] = 0.f; } }
    float m = -INFINITY, l = 0.f, R = 0.f; const float Ft = (MODE == 0) ? Fc[(size_t)bh * SEQ + t] : 0.f;
    for (int s = (MODE == 0 ? t : t - 1); s >= 0; --s) {
        const bf16* kp = QKV + (rowbase + s) * 3072 + kcol + h * 64; const bf16* vp = QKV + (rowbase + s) * 3072 + vcol + h * 64;
        float dot = 0.f;
#pragma unroll
        for (int d = 0; d < 64; ++d) dot += q[d] * __uint_as_float((unsigned)kp[d] << 16);
        const float z = dot * 0.125f;
        float w;
        if (MODE == 0) { const float zz = z + Ft - Fc[(size_t)bh * SEQ + s]; const float mn = fmaxf(m, zz), al = expf(m - mn); w = expf(zz - mn); l = l * al + w; m = mn;
#pragma unroll
            for (int d = 0; d < 64; ++d) o[d] *= al; }
        else { const float sp = fmaxf(z, 0.f) + log1pf(expf(-fabsf(z))); w = expf(z - sp - R); R += sp; if (R > 200.f) { s = 0; } }
#pragma unroll
        for (int d = 0; d < 64; ++d) o[d] += w * __uint_as_float((unsigned)vp[d] << 16);
    }
    const float inv = (MODE == 0) ? 1.f / l : 1.f;
    bf16* op = AO + (rowbase + t) * 512 + h * 64;
#pragma unroll
    for (int d = 0; d < 64; ++d) op[d] = (bf16)f2bf(o[d] * inv);
}
#endif

#ifndef DBG_G1
#define DBG_G1 1.0f
#endif
#ifndef DBG_G2
#define DBG_G2 1.0f
#endif

#ifdef DEBUG_DUMP
#define DUMP_BF16S(k, buf) if (DEBUG_DUMP == (k)) { for (size_t i = (size_t)bx * 512 + tid; i < (size_t)M * D / 2; i += (size_t)G * 512) { const unsigned w = __hip_atomic_load((const unsigned*)(buf) + i, __ATOMIC_RELAXED, DUMP_SCOPE); out[2 * i] = 1e3f * __uint_as_float(w << 16); out[2 * i + 1] = 1e3f * __uint_as_float(w & 0xffff0000u); } return; }
#define DUMP_BF16(k, buf) if (DEBUG_DUMP == (k)) { for (size_t i = (size_t)bx * 512 + tid; i < (size_t)M * D; i += (size_t)G * 512) out[i] = 1e3f * __uint_as_float((unsigned)(buf)[i] << 16); return; }
#define DUMP_F32(k, buf) if (DEBUG_DUMP == (k)) { for (size_t i = (size_t)bx * 512 + tid; i < (size_t)M * D; i += (size_t)G * 512) out[i] = 1e3f * (buf)[i]; return; }
#else
#define DUMP_BF16(k, buf)
#define DUMP_BF16S(k, buf)
#define DUMP_F32(k, buf)
#endif
#ifndef MK_LAUNCHES
#define MK_LAUNCHES 1
#endif
struct Args { const float* in[17]; float* out; unsigned char* ws; int ph_lo, ph_hi; };

__global__ void __launch_bounds__(NWAVES * 64, 2) fwd_megakernel(Args args) {
    extern __shared__ __attribute__((aligned(16))) unsigned char lds_raw[];
    LAS unsigned char* lds = (LAS unsigned char*)lds_raw;
#if MK_LAUNCHES == 1
    cg::grid_group grid = cg::this_grid();
#endif
    const int tid = threadIdx.x, lane = tid & 63, wave = __builtin_amdgcn_readfirstlane(tid >> 6);
    const int G = gridDim.x, bx = blockIdx.x;
    const int gw = bx * NWAVES + wave, NGW = G * NWAVES;
    unsigned char* ws = args.ws;
    const float* x = args.in[0]; const float* cvec = args.in[1]; const float* w_ada = args.in[2]; const float* b_ada = args.in[3]; const float* w_in = args.in[4];
    const float* b_gate = args.in[5]; const float* b_forget = args.in[6]; const float* w_sb = args.in[7]; const float* w_fx = args.in[8]; const float* w_o = args.in[9];
    const float* ln1_g = args.in[10]; const float* ln1_b = args.in[11]; const float* w_g = args.in[12]; const float* w_u = args.in[13]; const float* w_d = args.in[14];
    const float* ln2_g = args.in[15]; const float* ln2_b = args.in[16];
    float* out = args.out;
    float* ada = (float*)(ws + WS_ADA); float* Fc = (float*)(ws + WS_F); float* Fpre = out;
    bf16* Win_t = (bf16*)(ws + WS_WIN); bf16* Wsb_t = (bf16*)(ws + WS_WSB); bf16* Wfx_t = (bf16*)(ws + WS_WFX); bf16* Wo_t = (bf16*)(ws + WS_WO); bf16* Wgu_t = (bf16*)(ws + WS_WGU); bf16* Wdn_t = (bf16*)(ws + WS_WDN);
    bf16* U = (bf16*)(ws + WS_U); bf16* QKV = (bf16*)(ws + WS_QKV); bf16* GATES = (bf16*)(ws + WS_GATES); bf16* AOS = (bf16*)(ws + WS_AOS); bf16* AOF = (bf16*)(ws + WS_AOF);
    bf16* MIX = (bf16*)(ws + WS_MIX); float* X1 = (float*)(ws + WS_X1); bf16* HM = (bf16*)(ws + WS_HM); float* Tb = (float*)(ws + WS_T); float* R1 = (float*)(ws + WS_R1); float* R2 = (float*)(ws + WS_R2);

#if MK_LAUNCHES == 1
    { volatile LAS unsigned* st0 = (volatile LAS unsigned*)(lds + 131072 + 64); if (tid < 2) st0[tid] = 0u; }
    __syncthreads();
    XcdBarrier xbar = xcd_barrier_post((unsigned*)(ws + WS_BAR), (volatile LAS unsigned*)(lds + 131072 + 64));
    volatile LAS unsigned* own = (volatile LAS unsigned*)(lds + 131072 + 128);
    if (tid == 0) own[0] = xb_add((unsigned*)(ws + WS_BAR) + 3584 + xbar.x, 1u);
    grid.sync();
#endif
#if MK_LAUNCHES == 1
#define GRID_SYNC() xcd_barrier(xbar)
#else
#define GRID_SYNC() do {} while (0)
#endif

    if (args.ph_lo <= 0 && 0 < args.ph_hi)
    {
        LAS float* scr = (LAS float*)(lds + wave * 16384);
        constexpr int I_A = 16 * 96, I_B = 16 * 64, I_SB = 8 * 32, I_FX = 8 * 32, I_O = 16 * 32, I_G = 16 * 88, I_U = 16 * 88, I_D = 44 * 32;
        constexpr int NITEMS = I_A + I_B + I_SB + I_FX + I_O + I_G + I_U + I_D;
        for (int it = gw; it < NITEMS; it += NGW) {
            int r = it;
            if (r < I_A) { const int kb = r / 96, nb = r % 96; transpose_item(w_in, INC, 32 * nb, 64 * kb, Win_t, D, 32 * nb, scr, lane); continue; } r -= I_A;
            if (r < I_B) { const int kb = r / 64, nb = r % 64; transpose_item(w_in, INC, 3080 + 32 * nb, 64 * kb, Win_t, D, 3072 + 32 * nb, scr, lane); continue; } r -= I_B;
            if (r < I_SB) { const int kb = r / 32, nb = r % 32; transpose_item(w_sb, D, 32 * nb, 64 * kb, Wsb_t, 512, 32 * nb, scr, lane); continue; } r -= I_SB;
            if (r < I_FX) { const int kb = r / 32, nb = r % 32; transpose_item(w_fx, D, 32 * nb, 64 * kb, Wfx_t, 512, 32 * nb, scr, lane); continue; } r -= I_FX;
            if (r < I_O) { const int kb = r / 32, nb = r % 32; transpose_item(w_o, D, 32 * nb, 64 * kb, Wo_t, D, 32 * nb, scr, lane); continue; } r -= I_O;
            if (r < I_G) { const int kb = r / 88, nb = r % 88; transpose_item(w_g, FF, 32 * nb, 64 * kb, Wgu_t, D, 256 * (nb >> 2) + 32 * (nb & 3), scr, lane); continue; } r -= I_G;
            if (r < I_U) { const int kb = r / 88, nb = r % 88; transpose_item(w_u, FF, 32 * nb, 64 * kb, Wgu_t, D, 256 * (nb >> 2) + 128 + 32 * (nb & 3), scr, lane); continue; } r -= I_U;
            { const int kb = r / 32, nb = r % 32; transpose_item(w_d, D, 32 * nb, 64 * kb, Wdn_t, FF, 32 * nb, scr, lane); }
        }
        for (int it = NGW - 1 - gw; it < 96 * 8; it += NGW) {
            const int cch = it % 96, kch = it / 96, col = 64 * cch + lane;
            float a0 = 0.f, a1 = 0.f, a2 = 0.f, a3 = 0.f;
            for (int k = 128 * kch; k < 128 * kch + 128; ++k) {
                const float w = w_ada[(size_t)k * NCOND + col];
                const float c0 = cvec[k], c1 = cvec[D + k], c2 = cvec[2 * D + k], c3 = cvec[3 * D + k];
                a0 += c0 / (1.f + expf(-c0)) * w; a1 += c1 / (1.f + expf(-c1)) * w; a2 += c2 / (1.f + expf(-c2)) * w; a3 += c3 / (1.f + expf(-c3)) * w;
            }
            const float bb = (kch == 0) ? b_ada[col] : 0.f; float* ap = ada + (size_t)kch * ADA_PSTRIDE + col;
            ap[0] = a0 + bb; ap[NCOND] = a1 + bb; ap[2 * NCOND] = a2 + bb; ap[3 * NCOND] = a3 + bb;
        }
    }
    GRID_SYNC();
#if MK_LAUNCHES == 1
    if (tid == 0) { unsigned xo_ = 0; for (unsigned j = 0; j < xbar.x; ++j) xo_ += (xb_ld((unsigned*)(ws + WS_BAR) + XB_XCNT(j)) > 0u) ? 1u : 0u; own[1] = xo_; }
    __syncthreads();
    if (tid == 0) { const int nloc_ = (int)((volatile LAS unsigned*)(lds + 131072 + 64))[0], nxcc_ = (int)((volatile LAS unsigned*)(lds + 131072 + 64))[1], xord_ = (int)own[1];
        const int t0_ = (64 * xord_) / nxcc_; own[2] = (unsigned)t0_; own[3] = (unsigned)((64 * (xord_ + 1)) / nxcc_ - t0_); own[4] = (unsigned)nloc_; }
    __syncthreads();
#define OWN() const int t0 = __builtin_amdgcn_readfirstlane((int)own[2]), ntile = __builtin_amdgcn_readfirstlane((int)own[3]), nloc = __builtin_amdgcn_readfirstlane((int)own[4]), rank = __builtin_amdgcn_readfirstlane((int)own[0])
#else
#define OWN() const int t0 = 8 * (bx & 7), ntile = 8, nloc = G >> 3, rank = bx >> 3
#endif
#define OWN_ROWS() OWN(); const int wl = rank * NWAVES + wave, NWL = nloc * NWAVES, rows_x = 256 * ntile, RPWX = (rows_x + NWL - 1) / NWL

    if (args.ph_lo <= 1 && 1 < args.ph_hi)
    {
        const int lane_p = opq(lane);
        LAS float* wf = (LAS float*)lds;
        for (int i = tid; i < D * 8; i += NWAVES * 64) { const int k = i >> 3, hh = i & 7; wf[hh * D + k] = w_in[(size_t)k * INC + 3072 + hh]; }
        __syncthreads();
        OWN_ROWS(); int curb = -1; f32x4 sc[4], sh[4];
        for (int ri = 0; ri < RPWX; ++ri) {
            const int lr = wl * RPWX + ri; if (lr >= rows_x) break;
            const int row = 256 * t0 + lr;
            const int b = row >> 12, t = row & 4095;
            if (b != curb) { curb = b;
#pragma unroll
                for (int j = 0; j < 4; ++j) { sh[j] = ada4(ada + (size_t)b * NCOND + 256 * j + 4 * lane_p); sc[j] = ada4(ada + (size_t)b * NCOND + D + 256 * j + 4 * lane_p); } }
            const f32x4* xr = (const f32x4*)(x + (size_t)row * D) + lane_p;
            f32x4 v[4]; float s = 0.f;
#pragma unroll
            for (int j = 0; j < 4; ++j) { v[j] = xr[64 * j]; s += (v[j].x + v[j].y) + (v[j].z + v[j].w); }
            const float mean = wave_sum(s) * (1.f / D); float s2 = 0.f;
#pragma unroll
            for (int j = 0; j < 4; ++j) { v[j] = v[j] - mean; s2 += (v[j].x * v[j].x + v[j].y * v[j].y) + (v[j].z * v[j].z + v[j].w * v[j].w); }
            const float rstd = 1.f / sqrtf(wave_sum(s2) * (1.f / D) + LN_EPS);
            float fa[8];
#pragma unroll
            for (int hh = 0; hh < 8; ++hh) fa[hh] = 0.f;
            unsigned long long* o8 = (unsigned long long*)(U + (size_t)row * D) + lane_p;
#pragma unroll
            for (int j = 0; j < 4; ++j) {
                f32x4 uu = v[j] * rstd * (sc[j] + 1.0f) + sh[j];
                o8[64 * j] = (unsigned long long)pk2(uu.x, uu.y) | ((unsigned long long)pk2(uu.z, uu.w) << 32);
#pragma unroll
                for (int hh = 0; hh < 8; ++hh) { const f32x4 w = *(const LAS f32x4*)(wf + hh * D + 256 * j + 4 * lane_p); fa[hh] += (uu.x * w.x + uu.y * w.y) + (uu.z * w.z + uu.w * w.w); }
            }
#pragma unroll
            for (int hh = 0; hh < 8; ++hh) fa[hh] = wave_sum(fa[hh]);
            if (lane_p < 8) { float fv = fa[0];
#pragma unroll
                for (int hh = 1; hh < 8; ++hh) fv = (lane_p == hh) ? fa[hh] : fv;
                Fpre[((size_t)b * 8 + lane_p) * SEQ + t] = log_sigmoid_f(fv + b_forget[lane_p]); }
        }
        __syncthreads();
    }
    GRID_SYNC();

    DUMP_BF16(1, U)
    DUMP_BF16(40, Win_t + (size_t)3072 * 1024)
    if (args.ph_lo <= 2 && 2 < args.ph_hi)
    {
        LAS float* sm = (LAS float*)lds;
        for (int seq = bx; seq < BATCH * NHEAD; seq += G) {
            float* fp = Fc + (size_t)seq * SEQ + tid * 8; const float* fq_ = Fpre + (size_t)seq * SEQ + tid * 8;
            f32x4 a = *(const f32x4*)fq_, b2 = *(const f32x4*)(fq_ + 4);
            float v[8] = {a.x, a.y, a.z, a.w, b2.x, b2.y, b2.z, b2.w};
#pragma unroll
            for (int i = 1; i < 8; ++i) v[i] += v[i - 1];
            float tot = v[7], inc = tot;
#pragma unroll
            for (int o = 1; o < 64; o <<= 1) { const float n = __shfl_up(inc, o); if (lane >= o) inc += n; }
            if (lane == 63) sm[wave] = inc;
            __syncthreads();
            float base = inc - tot;
            for (int w = 0; w < wave; ++w) base += sm[w];
#pragma unroll
            for (int i = 0; i < 8; ++i) v[i] += base;
            *(f32x4*)fp = (f32x4){v[0], v[1], v[2], v[3]}; *(f32x4*)(fp + 4) = (f32x4){v[4], v[5], v[6], v[7]};
            __syncthreads();
        }
        OWN(); pg8::Gemm g{U, Win_t, M, NPROJ, D}; pg8::XccOrder S{t0, ntile, NPROJ / 256, nloc, rank};
        pg8::EpiProj E{QKV, GATES, b_gate};
        pg8::gemm_phase<pg8::EpiProj, pg8::XccOrder, true, true>(lds, g, S, E);
    }
    GRID_SYNC();

    DUMP_BF16(2, QKV)
    DUMP_BF16(22, QKV + (size_t)10922 * 3072)
    DUMP_BF16(12, GATES)
    DUMP_BF16S(13, GATES)
    if (args.ph_lo <= 3 && 3 < args.ph_hi)
#ifdef DEBUG_NAIVE_ATTN
    for (int gt = bx * (NWAVES * 64) + tid; gt < BATCH * NHEAD * SEQ; gt += G * NWAVES * 64) {
#ifdef DEBUG_DIAG
        naive_attn<0>(QKV, 1536, 2048, 2560, Fc, U, gt);
        naive_attn<1>(QKV, 0, 512, 1024, nullptr, U + (size_t)M * 512, gt);
#else
#if DEBUG_NAIVE_ATTN & 1
        naive_attn<0>(QKV, 1536, 2048, 2560, Fc, AOF, gt);
#endif
#if DEBUG_NAIVE_ATTN & 2
        naive_attn<1>(QKV, 0, 512, 1024, nullptr, AOS, gt);
#endif
#endif
    }
    __syncthreads();
#endif
    for (int u = bx; u < 1024; u += G) {
        const int j = u >> 8, w = u & 255, kind = j >> 1, bh = w >> 3, s = w & 7, qb = (j & 1) ? 15 - s : s;
#ifdef DEBUG_NAIVE_ATTN
#ifndef DEBUG_DIAG
        if ((kind == 0 && (DEBUG_NAIVE_ATTN & 1)) || (kind == 1 && (DEBUG_NAIVE_ATTN & 2))) continue;
#endif
#endif
        if (kind == 0) att::attn_unit<0>(lds, QKV, 1536, 2048, 2560, Fc + (size_t)bh * SEQ, AOF, bh >> 3, bh & 7, qb);
        else att::attn_unit<1>(lds, QKV, 0, 512, 1024, nullptr, AOS, bh >> 3, bh & 7, qb);
    }
    GRID_SYNC();

#ifdef DEBUG_DIAG
    { const size_t n = (size_t)M * 512; const bf16* U2 = U + n;
      for (size_t i = (size_t)bx * 512 + tid; i < n; i += (size_t)G * 512) {
          out[i] = DEBUG_DIAG_SF * (__uint_as_float((unsigned)AOF[i] << 16) - __uint_as_float((unsigned)U[i] << 16));
          out[n + i] = DEBUG_DIAG_SS * (__uint_as_float((unsigned)AOS[i] << 16) - __uint_as_float((unsigned)U2[i] << 16)); }
      return; }
#endif
    DUMP_BF16(3, AOS)
    if (args.ph_lo <= 4 && 4 < args.ph_hi)
    {
        OWN();
        { pg8::Gemm g{AOS, Wsb_t, M, D, 512}; pg8::XccOrder S{t0, ntile, D / 256, nloc, rank}; pg8::EpiGate1 E{GATES, Tb};
          pg8::gemm_phase<pg8::EpiGate1, pg8::XccOrder, true, true>(lds, g, S, E); }
#ifdef DEBUG_DUMP
        if (DEBUG_DUMP == 32) { pg8::Gemm g{AOS, Wsb_t, M, D, 512}; pg8::XccOrder S{t0, ntile, D / 256, nloc, rank}; pg8::EpiGate1 E{GATES, out};
          pg8::gemm_phase<pg8::EpiGate1, pg8::XccOrder, true, true>(lds, g, S, E); return; }
        if (DEBUG_DUMP == 31) { GRID_SYNC(); }
        DUMP_F32(31, Tb)
#endif
#ifdef DEBUG_DIAG_T2
        { pg8::Gemm g{AOS, Wsb_t, M, D, 512}; pg8::XccOrder S{t0, ntile, D / 256, nloc, rank}; pg8::EpiGateDiff E{GATES, out, DEBUG_DIAG_T2};
          pg8::gemm_phase<pg8::EpiGateDiff, pg8::XccOrder, true, true>(lds, g, S, E); }
        return;
#endif
#ifdef DEBUG_DIAG_T
        GRID_SYNC();
        for (size_t i = (size_t)bx * 512 + tid; i < (size_t)M * 1024; i += (size_t)G * 512) {
            const size_t r = i >> 10; const int c = (int)(i & 1023); float acc = 0.f;
            for (int k = 0; k < 512; ++k) acc += __uint_as_float((unsigned)AOS[r * 512 + k] << 16) * __uint_as_float(f2bf(w_sb[(size_t)k * 1024 + c]) << 16);
            const float tn = __uint_as_float((unsigned)GATES[r * 2048 + c] << 16) * acc;
            out[i] = DEBUG_DIAG_T * (__hip_atomic_load(Tb + i, __ATOMIC_RELAXED, __HIP_MEMORY_SCOPE_AGENT) - tn); }
        return;
#endif
        { pg8::Gemm g{AOF, Wfx_t, M, D, 512}; pg8::XccOrder S{t0, ntile, D / 256, nloc, rank}; pg8::EpiGate2 E{GATES, Tb, MIX};
          pg8::gemm_phase<pg8::EpiGate2, pg8::XccOrder, true, true>(lds, g, S, E); }
    }
    GRID_SYNC();

    DUMP_BF16(4, MIX)
    if (args.ph_lo <= 5 && 5 < args.ph_hi)
    {
        OWN(); pg8::Gemm g{MIX, Wo_t, M, D, D}; pg8::XccOrder S{t0, ntile, D / 256, nloc, rank}; pg8::EpiRes E{x, ada + 2 * D, R1, ALPHA, DBG_G1};
        pg8::gemm_phase<pg8::EpiRes, pg8::XccOrder, true, true>(lds, g, S, E);
    }
    GRID_SYNC();

    DUMP_F32(5, R1)
    if (args.ph_lo <= 6 && 6 < args.ph_hi)
    {
        const int lane_p = opq(lane);
        f32x4 gg[4], gb[4];
#pragma unroll
        for (int j = 0; j < 4; ++j) { gg[j] = *(const f32x4*)(ln1_g + 256 * j + 4 * lane_p); gb[j] = *(const f32x4*)(ln1_b + 256 * j + 4 * lane_p); }
        OWN_ROWS(); int curb = -1; f32x4 sc[4], sh[4];
        for (int ri = 0; ri < RPWX; ++ri) {
            const int lr = wl * RPWX + ri; if (lr >= rows_x) break;
            const int row = 256 * t0 + lr;
            const int b = row >> 12;
            if (b != curb) { curb = b;
#pragma unroll
                for (int j = 0; j < 4; ++j) { sh[j] = ada4(ada + (size_t)b * NCOND + 3 * D + 256 * j + 4 * lane_p); sc[j] = ada4(ada + (size_t)b * NCOND + 4 * D + 256 * j + 4 * lane_p); } }
            const f32x4* xr = (const f32x4*)(R1 + (size_t)row * D) + lane_p;
            f32x4 v[4]; float s = 0.f;
#pragma unroll
            for (int j = 0; j < 4; ++j) { v[j] = xr[64 * j]; s += (v[j].x + v[j].y) + (v[j].z + v[j].w); }
            float mean = wave_sum(s) * (1.f / D); float s2 = 0.f;
#pragma unroll
            for (int j = 0; j < 4; ++j) { v[j] = v[j] - mean; s2 += (v[j].x * v[j].x + v[j].y * v[j].y) + (v[j].z * v[j].z + v[j].w * v[j].w); }
            float rstd = 1.f / sqrtf(wave_sum(s2) * (1.f / D) + LN_EPS);
            f32x4* x1r = (f32x4*)(X1 + (size_t)row * D) + lane_p; s = 0.f;
#pragma unroll
            for (int j = 0; j < 4; ++j) { v[j] = v[j] * rstd * gg[j] + gb[j]; x1r[64 * j] = v[j]; s += (v[j].x + v[j].y) + (v[j].z + v[j].w); }
            mean = wave_sum(s) * (1.f / D); s2 = 0.f;
#pragma unroll
            for (int j = 0; j < 4; ++j) { v[j] = v[j] - mean; s2 += (v[j].x * v[j].x + v[j].y * v[j].y) + (v[j].z * v[j].z + v[j].w * v[j].w); }
            rstd = 1.f / sqrtf(wave_sum(s2) * (1.f / D) + LN_EPS);
            unsigned long long* o8 = (unsigned long long*)(U + (size_t)row * D) + lane_p;
#pragma unroll
            for (int j = 0; j < 4; ++j) { const f32x4 uu = v[j] * rstd * (sc[j] + 1.0f) + sh[j];
                o8[64 * j] = (unsigned long long)pk2(uu.x, uu.y) | ((unsigned long long)pk2(uu.z, uu.w) << 32); }
        }
    }
    GRID_SYNC();

    DUMP_F32(6, X1)
    DUMP_BF16(16, U)
    if (args.ph_lo <= 7 && 7 < args.ph_hi)
    {
        OWN(); pg8::Gemm g{U, Wgu_t, M, NGU, D}; pg8::XccOrder S{t0, ntile, NGU / 256, nloc, rank}; pg8::EpiSwiGLU E{HM, FF};
        pg8::gemm_phase<pg8::EpiSwiGLU, pg8::XccOrder, true, true>(lds, g, S, E);
    }
    GRID_SYNC();

    DUMP_BF16(7, HM)
    if (args.ph_lo <= 8 && 8 < args.ph_hi)
    {
        OWN(); pg8::Gemm g{HM, Wdn_t, M, D, FF}; pg8::XccOrder S{t0, ntile, D / 256, nloc, rank}; pg8::EpiRes E{X1, ada + 5 * D, R2, ALPHA, DBG_G2};
        pg8::gemm_phase<pg8::EpiRes, pg8::XccOrder, true, true>(lds, g, S, E);
    }
    GRID_SYNC();

    DUMP_F32(8, R2)
    if (args.ph_lo <= 9 && 9 < args.ph_hi)
    {
        const int lane_p = opq(lane);
        f32x4 gg[4], gb[4];
#pragma unroll
        for (int j = 0; j < 4; ++j) { gg[j] = *(const f32x4*)(ln2_g + 256 * j + 4 * lane_p); gb[j] = *(const f32x4*)(ln2_b + 256 * j + 4 * lane_p); }
        OWN_ROWS();
        for (int ri = 0; ri < RPWX; ++ri) {
            const int lr = wl * RPWX + ri; if (lr >= rows_x) break;
            const int row = 256 * t0 + lr;
            const f32x4* xr = (const f32x4*)(R2 + (size_t)row * D) + lane_p; f32x4* orow = (f32x4*)(out + (size_t)row * D) + lane_p;
            f32x4 v[4]; float s = 0.f;
#pragma unroll
            for (int j = 0; j < 4; ++j) { v[j] = xr[64 * j]; s += (v[j].x + v[j].y) + (v[j].z + v[j].w); }
            const float mean = wave_sum(s) * (1.f / D); float s2 = 0.f;
#pragma unroll
            for (int j = 0; j < 4; ++j) { v[j] = v[j] - mean; s2 += (v[j].x * v[j].x + v[j].y * v[j].y) + (v[j].z * v[j].z + v[j].w * v[j].w); }
            const float rstd = 1.f / sqrtf(wave_sum(s2) * (1.f / D) + LN_EPS);
#pragma unroll
            for (int j = 0; j < 4; ++j) orow[64 * j] = v[j] * rstd * gg[j] + gb[j];
        }
    }
}

extern "C" void kernel_launch(void* const* d_in, const int* in_sizes, int n_in, void* d_out, int out_size, void* d_ws, size_t ws_size, hipStream_t stream) {
    static int grid = 0;
    if (grid == 0) {
        if (n_in != 17 || out_size != M * D || ws_size < WS_END) { fprintf(stderr, "kernel_launch: unexpected shapes (n_in %d out %d ws %zu)\n", n_in, out_size, ws_size); grid = -1; return; }
        int dev = 0, cus = 0, per_cu = 0;
        if (hipGetDevice(&dev) != hipSuccess || hipDeviceGetAttribute(&cus, hipDeviceAttributeMultiprocessorCount, dev) != hipSuccess) { grid = -1; return; }
        if (hipFuncSetAttribute((const void*)fwd_megakernel, hipFuncAttributeMaxDynamicSharedMemorySize, LDS_BYTES) != hipSuccess) { fprintf(stderr, "kernel_launch: hipFuncSetAttribute failed\n"); grid = -1; return; }
        if (hipOccupancyMaxActiveBlocksPerMultiprocessor(&per_cu, (const void*)fwd_megakernel, NWAVES * 64, LDS_BYTES) != hipSuccess || per_cu < 1) { fprintf(stderr, "kernel_launch: occupancy query gives %d\n", per_cu); per_cu = 1; }
        (void)hipGetLastError();
        grid = cus;
    }
    if (grid < 0) return;
    Args a{};
    for (int i = 0; i < 17; ++i) a.in[i] = (const float*)d_in[i];
    a.out = (float*)d_out; a.ws = (unsigned char*)d_ws;
#if MK_LAUNCHES == 1
    (void)hipMemsetAsync((char*)d_ws + WS_BAR, 0, CTL_ZERO_BYTES, stream);
    a.ph_lo = 0; a.ph_hi = 10;
    void* kargs[] = {&a};
    hipError_t e = hipLaunchCooperativeKernel((const void*)fwd_megakernel, dim3(grid), dim3(NWAVES * 64), kargs, LDS_BYTES, stream);
    if (e != hipSuccess) fprintf(stderr, "cooperative launch failed: %s (grid %d)\n", hipGetErrorString(e), grid);
#else
    for (int ph = 0; ph < 10; ++ph) { a.ph_lo = ph; a.ph_hi = ph + 1; hipLaunchKernelGGL(fwd_megakernel, dim3(grid), dim3(NWAVES * 64), LDS_BYTES, stream, a); }
#endif
}
```
